# Optimizing an MI355X kernel written in HIP

```python
import jax, jax.numpy as jnp
from jax import lax
import numpy as np

D_MODEL = 2048
BATCH = 4
SEQ = 2048
DEPTH = 2

CHUNK = 64
EPS = 1e-6
D_POOL = D_MODEL // 2
POOL_WINDOWS = (2, 4, 8, 16)
N_POOL_GROUPS = len(POOL_WINDOWS)
POOL_GROUP = D_POOL // N_POOL_GROUPS
D_CONV = D_MODEL // 2
CONV_K = 31
D_AB_IN = D_POOL + 2 * D_CONV
D_SHORT = D_MODEL
SHORT_K = 3
D_FF = 4 * D_MODEL

N_EVEN = (DEPTH + 1) // 2
N_ODD = DEPTH // 2

kernel_name = "hybrid_pool_conformer_shortconv_trunk"


def rms_norm(x, g):
    xf = x.astype(jnp.float32)
    y = xf * lax.rsqrt(jnp.mean(xf * xf, axis=-1, keepdims=True) + EPS)
    return (y * g.astype(jnp.float32)).astype(x.dtype)


def layer_norm(x, g, b):
    xf = x.astype(jnp.float32)
    mu = jnp.mean(xf, axis=-1, keepdims=True)
    xc = xf - mu
    var = jnp.mean(xc * xc, axis=-1, keepdims=True)
    y = xc * lax.rsqrt(var + EPS) * g.astype(jnp.float32) + b.astype(jnp.float32)
    return y.astype(x.dtype)


def causal_depthwise_conv(u, w):
    k = w.shape[0]
    return lax.conv_general_dilated(
        u, w[:, None, :].astype(u.dtype), window_strides=(1,), padding=[(k - 1, 0)],
        dimension_numbers=("NWC", "WIO", "NWC"), feature_group_count=u.shape[-1])


def multiscale_pool(u, pool_w, pool_scale):
    b, t, _ = u.shape
    uf = u.astype(jnp.float32)
    csp = jnp.pad(jnp.cumsum(uf, axis=1), ((0, 0), (1, 0), (0, 0)))
    n_valid = jnp.arange(1, t + 1, dtype=jnp.float32)
    means = []
    for g, w in enumerate(POOL_WINDOWS):
        c = csp[..., g * POOL_GROUP:(g + 1) * POOL_GROUP]
        lag = jnp.pad(c, ((0, 0), (w - 1, 0), (0, 0)))[:, :t]
        cnt = jnp.minimum(n_valid, float(w))[None, :, None]
        means.append((c[:, 1:] - lag) / cnt)
    pooled = (jnp.concatenate(means, axis=-1) - uf).astype(u.dtype)
    pooled = pooled.reshape(b, t, N_POOL_GROUPS, POOL_GROUP)
    mixed = jnp.einsum("btgc,gce->btge", pooled, pool_w).reshape(b, t, D_POOL)
    return mixed * pool_scale


def pool_conformer_mixer(h, w_in, pool_w, pool_scale, conv_w, conv_b, ln_g, ln_b, w_out):
    z = jnp.einsum("btd,de->bte", h, w_in)
    u_pool = z[..., :D_POOL]
    v = z[..., D_POOL:D_POOL + D_CONV]
    gate = z[..., D_POOL + D_CONV:]
    y_pool = multiscale_pool(u_pool, pool_w, pool_scale)
    c = causal_depthwise_conv(v * jax.nn.sigmoid(gate), conv_w) + conv_b
    y_conv = jax.nn.silu(layer_norm(c, ln_g, ln_b))
    y = jnp.concatenate([y_pool, y_conv], axis=-1)
    return jnp.einsum("bte,ed->btd", y, w_out)


def short_conv_mixer(h, w_in, conv_w, w_out):
    z = jnp.einsum("btd,de->bte", h, w_in)
    b_gate = z[..., :D_SHORT]
    c_gate = z[..., D_SHORT:2 * D_SHORT]
    u = z[..., 2 * D_SHORT:]
    y = b_gate * causal_depthwise_conv(c_gate * u, conv_w)
    return jnp.einsum("bte,ed->btd", y, w_out)


def sq_relu_mlp(h, w1, w2):
    a = jax.nn.relu(jnp.einsum("btd,df->btf", h, w1))
    return jnp.einsum("btf,fd->btd", a * a, w2)


def setup_inputs(seed: int = 0) -> dict:
    key = jax.random.key(seed)
    ks = jax.random.split(key, 20)
    f32 = jnp.float32

    def nrm(k, shape, scale):
        return jax.random.normal(k, shape, f32) * scale

    def gain(k, shape):
        return 1.0 + 0.02 * jax.random.normal(k, shape, f32)

    return {
        "x": jax.random.normal(ks[0], (BATCH, SEQ, D_MODEL), f32),
        "mix_pre_g": gain(ks[1], (DEPTH, D_MODEL)),
        "mix_post_g": gain(ks[2], (DEPTH, D_MODEL)),
        "ffn_pre_g": gain(ks[3], (DEPTH, D_MODEL)),
        "ffn_post_g": gain(ks[4], (DEPTH, D_MODEL)),
        "ab_w_in": nrm(ks[5], (N_EVEN, D_MODEL, D_AB_IN), D_MODEL ** -0.5),
        "pool_w": nrm(ks[6], (N_EVEN, N_POOL_GROUPS, POOL_GROUP, POOL_GROUP), POOL_GROUP ** -0.5),
        "pool_scale": 1.0 + 0.1 * jax.random.normal(ks[7], (N_EVEN, D_POOL), f32),
        "conv_w": nrm(ks[8], (N_EVEN, CONV_K, D_CONV), CONV_K ** -0.5),
        "conv_b": nrm(ks[9], (N_EVEN, D_CONV), 0.02),
        "conv_ln_g": gain(ks[10], (N_EVEN, D_CONV)),
        "conv_ln_b": nrm(ks[11], (N_EVEN, D_CONV), 0.02),
        "ab_w_out": nrm(ks[12], (N_EVEN, D_POOL + D_CONV, D_MODEL), (D_POOL + D_CONV) ** -0.5),
        "sc_w_in": nrm(ks[13], (N_ODD, D_MODEL, 3 * D_SHORT), D_MODEL ** -0.5),
        "sc_conv_w": nrm(ks[14], (N_ODD, SHORT_K, D_SHORT), SHORT_K ** -0.5),
        "sc_w_out": nrm(ks[15], (N_ODD, D_SHORT, D_MODEL), D_SHORT ** -0.5),
        "ffn_w1": nrm(ks[16], (DEPTH, D_MODEL, D_FF), D_MODEL ** -0.5),
        "ffn_w2": nrm(ks[17], (DEPTH, D_FF, D_MODEL), D_FF ** -0.5),
    }


def reference(x, mix_pre_g, mix_post_g, ffn_pre_g, ffn_post_g, ab_w_in, pool_w, pool_scale,
              conv_w, conv_b, conv_ln_g, conv_ln_b, ab_w_out, sc_w_in, sc_conv_w, sc_w_out,
              ffn_w1, ffn_w2):
    for layer in range(DEPTH):
        i = layer // 2
        h = rms_norm(x, mix_pre_g[layer])
        if layer % 2 == 0:
            m = pool_conformer_mixer(h, ab_w_in[i], pool_w[i], pool_scale[i], conv_w[i], conv_b[i],
                                     conv_ln_g[i], conv_ln_b[i], ab_w_out[i])
        else:
            m = short_conv_mixer(h, sc_w_in[i], sc_conv_w[i], sc_w_out[i])
        x = x + rms_norm(m, mix_post_g[layer])
        h = rms_norm(x, ffn_pre_g[layer])
        x = x + rms_norm(sq_relu_mlp(h, ffn_w1[layer], ffn_w2[layer]), ffn_post_g[layer])
    return x
```

```cpp
#include <hip/hip_runtime.h>
#include <hip/hip_cooperative_groups.h>
#include <cstdio>
#include <cstdint>
namespace cg = cooperative_groups;

#ifndef MK_MULTI_LAUNCH
#define MK_MULTI_LAUNCH 1
#endif

#define LAS __attribute__((address_space(3)))
typedef unsigned short bf16_t;
typedef short bf16x8 __attribute__((ext_vector_type(8)));
typedef float f32x4 __attribute__((ext_vector_type(4)));
typedef float f32x2 __attribute__((ext_vector_type(2)));
typedef unsigned u32x4 __attribute__((ext_vector_type(4)));
typedef unsigned u32x2 __attribute__((ext_vector_type(2)));

constexpr int DM = 2048, SEQ = 2048, NB = 4, MROWS = NB * SEQ;
constexpr int DPOOL = 1024, DCONV = 1024, DAB = 3072, DFF = 8192, DSC3 = 6144, CONVK = 31;
constexpr float EPS = 1e-6f;

constexpr size_t MiB = 1u << 20;
constexpr size_t WS_WIN0 = 0 * MiB, WS_POOLW = 12 * MiB, WS_WOUT0 = 13 * MiB, WS_W1_0 = 21 * MiB, WS_W2_0 = 53 * MiB, WS_SCIN = 85 * MiB, WS_SCOUT = 109 * MiB,
                 WS_W1_1 = 117 * MiB, WS_W2_1 = 149 * MiB, WS_H = 181 * MiB, WS_Z = 213 * MiB, WS_Y = 309 * MiB, WS_AF = WS_Z  ,
                 WS_POOLED = 341 * MiB, WS_MOUT = 357 * MiB, WS_END = 421 * MiB;

constexpr int LDS_BYTES = 147456;

__device__ __forceinline__ unsigned cvt_pk_bf16(float lo, float hi) { unsigned r; asm volatile("v_cvt_pk_bf16_f32 %0, %1, %2" : "=v"(r) : "v"(lo), "v"(hi)); return r; }
__device__ __forceinline__ float bf_lo(unsigned w) { return __uint_as_float(w << 16); }
__device__ __forceinline__ float bf_hi(unsigned w) { return __uint_as_float(w & 0xffff0000u); }
typedef __amdgpu_buffer_rsrc_t rsrc_t;
__device__ __forceinline__ rsrc_t mk_rsrc(const void* p) { return __builtin_amdgcn_make_buffer_rsrc((void*)p, 0, 0x7fffffff, 0x00020000); }
__device__ __forceinline__ unsigned bld_u32(rsrc_t r, unsigned voff, unsigned soff) { return __builtin_amdgcn_raw_buffer_load_b32(r, voff, soff, 0); }
__device__ __forceinline__ void bst_u32(rsrc_t r, unsigned voff, unsigned soff, unsigned v) { __builtin_amdgcn_raw_buffer_store_b32(v, r, voff, soff, 0); }
__device__ __forceinline__ float wave_sum(float v) {
#pragma unroll
    for (int o = 1; o < 64; o <<= 1) v += __shfl_xor(v, o);
    return v;
}

namespace pg8 {
constexpr int BM = 256, BK = 64, HALF = 128, HTB = HALF * BK * 2, STAGE_BYTES = 8 * HTB, NXCD = 8, WGM = 8;
__host__ __device__ __forceinline__ int lds_byte(int r, int c) { const int st = (r >> 4) * 2 + (c >> 5), rr = r & 15, cc = c & 31, ob = rr * 64 + cc * 2; return st * 1024 + (ob ^ (((ob >> 9) & 1) << 5)); }
__host__ __device__ __forceinline__ void stage_rc(int b, int& R, int& C) { const int st = b / 1024, sb = b % 1024, swz = sb ^ (((sb >> 9) & 1) << 5); R = (st >> 1) * 16 + swz / 64; C = (st & 1) * 32 + (swz % 64) / 2; }
__host__ __device__ __forceinline__ int perm32(int rho) { const int n = rho >> 4, i = rho & 15; return 8 * (i >> 2) + 4 * n + (i & 3); }

struct Unit { int pm, pn; };
struct Gemm { const bf16_t* A; const bf16_t* Bt; int M, N, K, lda, a_pn_off; };
struct Epi { void* out; int ldc; int mode; };

struct StaticOrder {
    int nM, nN, nwg, G, c;
    __host__ __device__ void init(int M, int N, int G_, int c_) { nM = M / BM; nN = N / BM; nwg = nM * nN; G = G_; c = c_; }
    __host__ __device__ bool next(int i, Unit& u) const {
        const long L = (long)i * G + c; if (L >= nwg) return false;
        int wgid = (int)L; { const int q = nwg / NXCD, r = nwg % NXCD, xcd = wgid % NXCD, off = wgid / NXCD; wgid = (xcd < r ? xcd * (q + 1) : r * (q + 1) + (xcd - r) * q) + off; }
        const int nig = WGM * nN, gid = wgid / nig, fm = gid * WGM, gsz = (nM - fm) < WGM ? (nM - fm) : WGM;
        u.pm = fm + ((wgid % nig) % gsz); u.pn = (wgid % nig) / gsz; return true;
    }
};

__device__ __forceinline__ void epi_store(const f32x4 (&acc)[2][2][4][2], const Epi& E, const Unit& u, int wr, int wc, int fr, int fq) {
    const int row0 = u.pm * BM + wr * 64 + fr;
    if (E.mode == 0) {
        float* C = (float*)E.out; const int col0 = u.pn * BM + wc * 32 + 4 * fq;
#pragma unroll
        for (int ai = 0; ai < 2; ++ai)
#pragma unroll
            for (int m = 0; m < 4; ++m) { float* rowp = C + (size_t)(row0 + ai * HALF + m * 16) * E.ldc + col0;
#pragma unroll
                for (int bj = 0; bj < 2; ++bj)
#pragma unroll
                    for (int n = 0; n < 2; ++n) *(f32x4*)(rowp + bj * HALF + n * 16) = acc[ai][bj][m][n]; }
    } else {
        bf16_t* O = (bf16_t*)E.out; const int col0 = u.pn * BM + wc * 32 + 8 * fq; const bool sq = (E.mode == 2);
#pragma unroll
        for (int ai = 0; ai < 2; ++ai)
#pragma unroll
            for (int m = 0; m < 4; ++m) { bf16_t* rowp = O + (size_t)(row0 + ai * HALF + m * 16) * E.ldc + col0;
#pragma unroll
                for (int bj = 0; bj < 2; ++bj) { f32x4 v0 = acc[ai][bj][m][0], v1 = acc[ai][bj][m][1];
                    if (sq) {
#pragma unroll
                        for (int j = 0; j < 4; ++j) { const float a = fmaxf(v0[j], 0.f), b = fmaxf(v1[j], 0.f); v0[j] = a * a; v1[j] = b * b; } }
                    u32x4 w; w.x = cvt_pk_bf16(v0[0], v0[1]); w.y = cvt_pk_bf16(v0[2], v0[3]); w.z = cvt_pk_bf16(v1[0], v1[1]); w.w = cvt_pk_bf16(v1[2], v1[3]);
                    *(u32x4*)(rowp + bj * HALF) = w; } }
    }
}

__device__ __forceinline__ void gemm_phase(LAS unsigned char* lds, const Gemm g, const StaticOrder& S, const Epi& E, const int tid) {
    const int wid = __builtin_amdgcn_readfirstlane(tid >> 6), lane = tid & 63, wr = wid >> 2, wc = wid & 3, fr = lane & 15, fq = lane >> 4;
    const int K = g.K, nt = K / BK, lda = g.lda;
    const bool perm = (E.mode != 0);
    unsigned voffA[2], voffB[2];
#pragma unroll
    for (int i = 0; i < 2; ++i) { int R, C; stage_rc(tid * 16 + i * 8192, R, C); const int Rb = perm ? ((R & ~31) + perm32(R & 31)) : R;
        voffA[i] = (unsigned)(R * lda + C) * 2u; voffB[i] = (unsigned)(Rb * K + C) * 2u; }
    const size_t kstep = (size_t)(BK * 2);
    const size_t hstepA = (size_t)HALF * lda * 2, hstepB = (size_t)HALF * K * 2;
    const size_t tstepA = 2 * hstepA, tstepB = 2 * hstepB, pnA = (size_t)g.a_pn_off * 2;
    const unsigned ldsw = (unsigned)wid * 1024u;
    const int aoff = lds_byte(wr * 64 + fr, fq * 8), boff = lds_byte(wc * 32 + fr, fq * 8);
#define PG8_SA(b, h) (((b) * 2 + (h)) * HTB)
#define PG8_SB(b, h) ((4 + (b) * 2 + (h)) * HTB)
#define PG8_STAGE(bufoff, gbase, voff) do { _Pragma("unroll") for (int _i = 0; _i < 2; ++_i) \
        __builtin_amdgcn_global_load_lds((const unsigned*)((const char*)(gbase) + (voff)[_i]), (LAS unsigned*)(lds + (bufoff) + ldsw + _i * 8192), 16, 0, 0); } while (0)
#define PG8_LDA(dst, b, h) do { _Pragma("unroll") for (int m = 0; m < 4; ++m) _Pragma("unroll") for (int k = 0; k < 2; ++k) dst[m][k] = *(const LAS bf16x8*)(lds + PG8_SA(b, h) + aoff + m * 2048 + k * 1024); } while (0)
#define PG8_LDB(dst, b, h) do { _Pragma("unroll") for (int n = 0; n < 2; ++n) _Pragma("unroll") for (int k = 0; k < 2; ++k) dst[n][k] = *(const LAS bf16x8*)(lds + PG8_SB(b, h) + boff + n * 2048 + k * 1024); } while (0)
#define PG8_MMA(ai, bj, At, Bt) do { __builtin_amdgcn_s_setprio(1); _Pragma("unroll") for (int m = 0; m < 4; ++m) _Pragma("unroll") for (int n = 0; n < 2; ++n) _Pragma("unroll") for (int k = 0; k < 2; ++k) \
        acc[ai][bj][m][n] = __builtin_amdgcn_mfma_f32_16x16x32_bf16(Bt[n][k], At[m][k], acc[ai][bj][m][n], 0, 0, 0); __builtin_amdgcn_s_setprio(0); } while (0)
#define PG8_WAIT_V(n) asm volatile("s_waitcnt vmcnt(" #n ")" ::: "memory")
#define PG8_WAIT_L(n) asm volatile("s_waitcnt lgkmcnt(" #n ")" ::: "memory")
#define PG8_BAR __builtin_amdgcn_s_barrier()
#define PG8_SCHED __builtin_amdgcn_sched_barrier(0)
    Unit cur, nxt; int ui = 0;
    if (!S.next(0, cur)) return;
    f32x4 acc[2][2][4][2];
#pragma unroll
    for (int a = 0; a < 2; ++a)
#pragma unroll
        for (int b = 0; b < 2; ++b)
#pragma unroll
            for (int m = 0; m < 4; ++m)
#pragma unroll
                for (int n = 0; n < 2; ++n) acc[a][b][m][n] = (f32x4){0.f, 0.f, 0.f, 0.f};
    bf16x8 At[4][2], B0[2][2], B1[2][2];
    const char* cA = (const char*)g.A + (size_t)cur.pm * tstepA + (size_t)cur.pn * pnA; const char* cB = (const char*)g.Bt + (size_t)cur.pn * tstepB;
    PG8_STAGE(PG8_SB(0, 0), cB, voffB); PG8_STAGE(PG8_SB(0, 1), cB + hstepB, voffB); PG8_STAGE(PG8_SA(0, 0), cA, voffA); PG8_STAGE(PG8_SA(0, 1), cA + hstepA, voffA);
    if (wr == 1) PG8_BAR;
    PG8_WAIT_V(2); PG8_BAR;
    PG8_STAGE(PG8_SB(1, 0), cB + kstep, voffB); PG8_STAGE(PG8_SA(1, 0), cA + kstep, voffA); PG8_STAGE(PG8_SB(1, 1), cB + hstepB + kstep, voffB);
    PG8_WAIT_V(6); PG8_BAR;
    for (;;) {
        const bool has_next = S.next(ui + 1, nxt);
        const char* nA = has_next ? (const char*)g.A + (size_t)nxt.pm * tstepA + (size_t)nxt.pn * pnA : cA; const char* nB = has_next ? (const char*)g.Bt + (size_t)nxt.pn * tstepB : cB;
        for (int t = 0; t < nt; t += 2) {
            const bool last = (t == nt - 2);
            const char* a1 = cA + (size_t)(t + 1) * kstep;
            const char* a2 = last ? nA : cA + (size_t)(t + 2) * kstep; const char* b2 = last ? nB : cB + (size_t)(t + 2) * kstep;
            const char* a3 = a2 + kstep; const char* b3 = b2 + kstep;
            PG8_LDB(B0, 0, 0); PG8_LDB(B1, 0, 1); PG8_SCHED; PG8_LDA(At, 0, 0); PG8_STAGE(PG8_SA(1, 1), a1 + hstepA, voffA);
            PG8_WAIT_V(8); PG8_WAIT_L(0); PG8_BAR; PG8_MMA(0, 0, At, B0); PG8_MMA(0, 1, At, B1); PG8_BAR; PG8_SCHED;
            PG8_LDA(At, 0, 1); PG8_STAGE(PG8_SB(0, 0), b2, voffB); PG8_STAGE(PG8_SB(0, 1), b2 + hstepB, voffB); PG8_STAGE(PG8_SA(0, 0), a2, voffA);
            PG8_WAIT_V(8); PG8_WAIT_L(0); PG8_BAR; PG8_MMA(1, 0, At, B0); PG8_MMA(1, 1, At, B1); PG8_BAR; PG8_SCHED;
            PG8_LDB(B0, 1, 0); PG8_LDB(B1, 1, 1); PG8_SCHED; PG8_LDA(At, 1, 0); PG8_STAGE(PG8_SA(0, 1), a2 + hstepA, voffA);
            PG8_WAIT_V(8); PG8_WAIT_L(0); PG8_BAR; PG8_MMA(0, 0, At, B0); PG8_MMA(0, 1, At, B1); PG8_BAR; PG8_SCHED;
            PG8_LDA(At, 1, 1); PG8_STAGE(PG8_SB(1, 0), b3, voffB); PG8_STAGE(PG8_SB(1, 1), b3 + hstepB, voffB); PG8_STAGE(PG8_SA(1, 0), a3, voffA);
            PG8_WAIT_V(8); PG8_WAIT_L(0); PG8_BAR; PG8_MMA(1, 0, At, B0); PG8_MMA(1, 1, At, B1); PG8_BAR; PG8_SCHED;
        }
        if (wr == 0) PG8_BAR;
        epi_store(acc, E, cur, wr, wc, fr, fq);
        if (!has_next) break;
#pragma unroll
        for (int a = 0; a < 2; ++a)
#pragma unroll
            for (int b = 0; b < 2; ++b)
#pragma unroll
                for (int m = 0; m < 4; ++m)
#pragma unroll
                    for (int n = 0; n < 2; ++n) acc[a][b][m][n] = (f32x4){0.f, 0.f, 0.f, 0.f};
        cur = nxt; cA = nA; cB = nB; ++ui;
        if (wr == 1) PG8_BAR;
    }
    PG8_WAIT_V(0);
    PG8_BAR;
#undef PG8_SA
#undef PG8_SB
#undef PG8_STAGE
#undef PG8_LDA
#undef PG8_LDB
#undef PG8_MMA
#undef PG8_WAIT_V
#undef PG8_WAIT_L
#undef PG8_BAR
#undef PG8_SCHED
}
}

__device__ __forceinline__ void tr_item(const float* __restrict__ W, int K, int N, bf16_t* __restrict__ WT, int item, const float* __restrict__ scale, int lane) {
    const int nblk = N >> 6, kb = item / nblk, nb = item - kb * nblk, k0 = kb << 6, n0 = nb << 6;
    const rsrc_t rw = mk_rsrc(W), rt = mk_rsrc(WT);
    const unsigned sbase = (unsigned)(k0 * N + n0) * 4u, vl = (unsigned)lane * 4u;
    float v[64];
#pragma unroll
    for (int k = 0; k < 64; ++k) v[k] = __uint_as_float(bld_u32(rw, vl, sbase + (unsigned)(k * N) * 4u));
    const float sc = scale ? scale[n0 + lane] : 1.f;
    const unsigned vd = (unsigned)(lane * K) * 2u, sd = (unsigned)(n0 * K + k0) * 2u;
#pragma unroll
    for (int j = 0; j < 8; ++j) { u32x4 o;
        o.x = cvt_pk_bf16(v[8 * j + 0] * sc, v[8 * j + 1] * sc); o.y = cvt_pk_bf16(v[8 * j + 2] * sc, v[8 * j + 3] * sc);
        o.z = cvt_pk_bf16(v[8 * j + 4] * sc, v[8 * j + 5] * sc); o.w = cvt_pk_bf16(v[8 * j + 6] * sc, v[8 * j + 7] * sc);
        __builtin_amdgcn_raw_buffer_store_b128(o, rt, vd, sd + 16u * j, 0); }
}

__device__ __forceinline__ void row_phase(const float* m_in, const float* x_in, const float* g_post, const float* g_next, float* x_out, bf16_t* h_out, int gw, int NGW, int lane) {
    for (int row = gw; row < MROWS; row += NGW) {
        const f32x4* xr = (const f32x4*)(x_in + (size_t)row * DM) + lane;
        f32x4 xv[8];
#pragma unroll
        for (int j = 0; j < 8; ++j) xv[j] = xr[64 * j];
        if (m_in) {
            const f32x4* mr = (const f32x4*)(m_in + (size_t)row * DM) + lane;
            f32x4 mv[8]; float ss = 0.f;
#pragma unroll
            for (int j = 0; j < 8; ++j) { mv[j] = mr[64 * j]; }
#pragma unroll
            for (int j = 0; j < 8; ++j) ss += (mv[j].x * mv[j].x + mv[j].y * mv[j].y) + (mv[j].z * mv[j].z + mv[j].w * mv[j].w);
            const float rstd = 1.0f / sqrtf(wave_sum(ss) * (1.0f / DM) + EPS);
            const f32x4* gp = (const f32x4*)g_post + lane;
#pragma unroll
            for (int j = 0; j < 8; ++j) { const f32x4 g = gp[64 * j]; xv[j] = xv[j] + (mv[j] * rstd) * g; }
        }
        if (x_out) { f32x4* xo = (f32x4*)(x_out + (size_t)row * DM) + lane;
#pragma unroll
            for (int j = 0; j < 8; ++j) xo[64 * j] = xv[j]; }
        if (h_out) {
            float ss = 0.f;
#pragma unroll
            for (int j = 0; j < 8; ++j) ss += (xv[j].x * xv[j].x + xv[j].y * xv[j].y) + (xv[j].z * xv[j].z + xv[j].w * xv[j].w);
            const float rstd = 1.0f / sqrtf(wave_sum(ss) * (1.0f / DM) + EPS);
            const f32x4* gn = (const f32x4*)g_next + lane;
            u32x2* ho = (u32x2*)(h_out + (size_t)row * DM) + lane;
#pragma unroll
            for (int j = 0; j < 8; ++j) { const f32x4 g = gn[64 * j]; const f32x4 h = (xv[j] * rstd) * g; u32x2 w; w.x = cvt_pk_bf16(h.x, h.y); w.y = cvt_pk_bf16(h.z, h.w); ho[64 * j] = w; }
        }
    }
}

constexpr int TT = 16;
template <int W> __device__ __forceinline__ void pool_part(rsrc_t rz, rsrc_t rp, int row0, bool first, int tid) {
    constexpr int NH = W - 1;
    const float hm = first ? 0.f : 1.f;
    const int hrow = first ? row0 : row0 - NH;
    f32x2 u[NH + TT];
    const unsigned voff = (unsigned)tid * 4u;
#pragma unroll
    for (int i = 0; i < NH; ++i) { const unsigned w = bld_u32(rz, voff, (unsigned)(hrow + (first ? 0 : i)) * (DAB * 2)); u[i] = (f32x2){bf_lo(w) * hm, bf_hi(w) * hm}; }
#pragma unroll
    for (int i = 0; i < TT; ++i) { const unsigned w = bld_u32(rz, voff, (unsigned)(row0 + i) * (DAB * 2)); u[NH + i] = (f32x2){bf_lo(w), bf_hi(w)}; }
#pragma unroll
    for (int j = 0; j < TT; ++j) {
        f32x2 s = u[NH + j];
#pragma unroll
        for (int i = 1; i < W; ++i) s += u[NH + j - i];
        const float cntf = (float)((j + 1) < W ? (j + 1) : W);
        const float cnt = first ? cntf : (float)W;
        const f32x2 r = s / cnt - u[NH + j];
        bst_u32(rp, voff, (unsigned)(row0 + j) * (DPOOL * 2), cvt_pk_bf16(r.x, r.y));
    }
}

__device__ __forceinline__ void mix0_item(const bf16_t* __restrict__ Z, bf16_t* __restrict__ P, bf16_t* __restrict__ Y, const float* __restrict__ conv_w, const float* __restrict__ conv_b,
                                          const float* __restrict__ ln_g, const float* __restrict__ ln_b, int it, LAS unsigned char* lds, int tid, int wid, int lane) {
    const int row0 = it * TT; const bool first = ((row0 & (SEQ - 1)) == 0);
    const rsrc_t rz = mk_rsrc(Z), rp = mk_rsrc(P), ry = mk_rsrc(Y);
    { const int grp = wid >> 1;
      if (grp == 0) pool_part<2>(rz, rp, row0, first, tid); else if (grp == 1) pool_part<4>(rz, rp, row0, first, tid);
      else if (grp == 2) pool_part<8>(rz, rp, row0, first, tid); else pool_part<16>(rz, rp, row0, first, tid); }
    const int c0 = 2 * tid;
    f32x2 w[CONVK];
#pragma unroll
    for (int k = 0; k < CONVK; ++k) w[k] = *(const f32x2*)(conv_w + k * DCONV + c0);
    f32x2 acc[TT];
#pragma unroll
    for (int j = 0; j < TT; ++j) acc[j] = (f32x2){0.f, 0.f};
    const int t0 = row0 & (SEQ - 1);
    const unsigned voff = (unsigned)tid * 4u;
    constexpr int NR = TT + CONVK - 1;
#pragma unroll
    for (int b0 = 0; b0 < NR; b0 += 16) {
        unsigned vv[16], gg[16];
#pragma unroll
        for (int q = 0; q < 16; ++q) { const int i = b0 + q; if (i < NR) { const int r = (t0 + i < CONVK - 1) ? row0 : row0 - (CONVK - 1) + i;
            vv[q] = bld_u32(rz, voff, (unsigned)r * (DAB * 2) + 2048u); gg[q] = bld_u32(rz, voff, (unsigned)r * (DAB * 2) + 4096u); } }
        asm volatile("" ::: "memory");
#pragma unroll
        for (int q = 0; q < 16; ++q) { const int i = b0 + q; if (i < NR) {
            const float m = (t0 + i < CONVK - 1) ? 0.f : 1.f;
            f32x2 s;
            s.x = bf_lo(vv[q]) * __builtin_amdgcn_rcpf(1.0f + __expf(-bf_lo(gg[q]))) * m;
            s.y = bf_hi(vv[q]) * __builtin_amdgcn_rcpf(1.0f + __expf(-bf_hi(gg[q]))) * m;
#pragma unroll
            for (int j = 0; j < TT; ++j) { const int k = i - j; if (k >= 0 && k < CONVK) acc[j] += w[k] * s; }
        } }
        asm volatile("" ::: "memory");
    }
    { const f32x2 cb = *(const f32x2*)(conv_b + c0);
#pragma unroll
      for (int j = 0; j < TT; ++j) acc[j] += cb; }
    LAS float* red = (LAS float*)lds;
    LAS float* stat = (LAS float*)(lds + 4096);
#pragma unroll
    for (int j = 0; j < TT; ++j) {
        float s = acc[j].x + acc[j].y, q = acc[j].x * acc[j].x + acc[j].y * acc[j].y;
        s = wave_sum(s); q = wave_sum(q);
        if (lane == 0) { red[wid * (2 * TT) + j] = s; red[wid * (2 * TT) + TT + j] = q; }
    }
    __syncthreads();
    if (tid < TT) { float s = 0.f, q = 0.f;
#pragma unroll
        for (int x = 0; x < 8; ++x) { s += red[x * (2 * TT) + tid]; q += red[x * (2 * TT) + TT + tid]; }
        const float mean = s * (1.0f / DCONV); const float var = fmaxf(q * (1.0f / DCONV) - mean * mean, 0.f);
        stat[2 * tid] = mean; stat[2 * tid + 1] = 1.0f / sqrtf(var + EPS); }
    __syncthreads();
    const f32x2 lg = *(const f32x2*)(ln_g + c0), lb = *(const f32x2*)(ln_b + c0);
#pragma unroll
    for (int j = 0; j < TT; ++j) {
        const float mean = stat[2 * j], rstd = stat[2 * j + 1];
        f32x2 y = ((acc[j] - mean) * rstd) * lg + lb;
        y.x = y.x * __builtin_amdgcn_rcpf(1.0f + __expf(-y.x)); y.y = y.y * __builtin_amdgcn_rcpf(1.0f + __expf(-y.y));
        bst_u32(ry, voff, (unsigned)(row0 + j) * (DM * 2) + 2048u, cvt_pk_bf16(y.x, y.y));
    }
    __syncthreads();
}

__device__ __forceinline__ void sc_chunk(const bf16_t* __restrict__ Z, bf16_t* __restrict__ Y, const float* __restrict__ cw, int chunk, int t8) {
    const int row0 = chunk * 16; const bool first = ((row0 & (SEQ - 1)) == 0); const int c0 = 8 * t8;
    float w0[8], w1[8], w2[8];
#pragma unroll
    for (int e = 0; e < 8; e += 4) { const f32x4 a = *(const f32x4*)(cw + c0 + e), b = *(const f32x4*)(cw + DM + c0 + e), c = *(const f32x4*)(cw + 2 * DM + c0 + e);
#pragma unroll
        for (int x = 0; x < 4; ++x) { w0[e + x] = a[x]; w1[e + x] = b[x]; w2[e + x] = c[x]; } }
    float p2[8], p1[8];
    { const float hm = first ? 0.f : 1.f; const int ra = first ? row0 : row0 - 2, rb = first ? row0 : row0 - 1;
      const u32x4 ca = *(const u32x4*)(Z + (size_t)ra * DSC3 + 2048 + c0), ua = *(const u32x4*)(Z + (size_t)ra * DSC3 + 4096 + c0);
      const u32x4 cb = *(const u32x4*)(Z + (size_t)rb * DSC3 + 2048 + c0), ub = *(const u32x4*)(Z + (size_t)rb * DSC3 + 4096 + c0);
#pragma unroll
      for (int x = 0; x < 4; ++x) { p2[2 * x] = bf_lo(ca[x]) * bf_lo(ua[x]) * hm; p2[2 * x + 1] = bf_hi(ca[x]) * bf_hi(ua[x]) * hm;
                                    p1[2 * x] = bf_lo(cb[x]) * bf_lo(ub[x]) * hm; p1[2 * x + 1] = bf_hi(cb[x]) * bf_hi(ub[x]) * hm; } }
#pragma unroll
    for (int h = 0; h < 2; ++h) {
        u32x4 bb[8], cc[8], uu[8];
#pragma unroll
        for (int r = 0; r < 8; ++r) { const bf16_t* zr = Z + (size_t)(row0 + 8 * h + r) * DSC3 + c0; bb[r] = *(const u32x4*)zr; cc[r] = *(const u32x4*)(zr + 2048); uu[r] = *(const u32x4*)(zr + 4096); }
#pragma unroll
        for (int r = 0; r < 8; ++r) {
            float cu[8], y[8];
#pragma unroll
            for (int x = 0; x < 4; ++x) { cu[2 * x] = bf_lo(cc[r][x]) * bf_lo(uu[r][x]); cu[2 * x + 1] = bf_hi(cc[r][x]) * bf_hi(uu[r][x]); }
#pragma unroll
            for (int x = 0; x < 4; ++x) {
                y[2 * x] = bf_lo(bb[r][x]) * (w0[2 * x] * p2[2 * x] + w1[2 * x] * p1[2 * x] + w2[2 * x] * cu[2 * x]);
                y[2 * x + 1] = bf_hi(bb[r][x]) * (w0[2 * x + 1] * p2[2 * x + 1] + w1[2 * x + 1] * p1[2 * x + 1] + w2[2 * x + 1] * cu[2 * x + 1]); }
            u32x4 o; o.x = cvt_pk_bf16(y[0], y[1]); o.y = cvt_pk_bf16(y[2], y[3]); o.z = cvt_pk_bf16(y[4], y[5]); o.w = cvt_pk_bf16(y[6], y[7]);
            *(u32x4*)(Y + (size_t)(row0 + 8 * h + r) * DM + c0) = o;
#pragma unroll
            for (int x = 0; x < 8; ++x) { p2[x] = p1[x]; p1[x] = cu[x]; }
        }
    }
}

struct Args { const float* in[18]; float* out; unsigned char* ws; int ph_lo, ph_hi, coop, pad; };
constexpr int NPHASES = 16;

__global__ void __launch_bounds__(512, 2) trunk_fwd(Args a) {
    extern __shared__ __attribute__((aligned(16))) unsigned char lds_raw[];
    LAS unsigned char* lds = (LAS unsigned char*)lds_raw;
    const int G = gridDim.x;
    for (int ph = a.ph_lo; ph < a.ph_hi; ++ph) {
        int tid = threadIdx.x, bid = blockIdx.x;
        asm volatile("" : "+v"(tid)); asm volatile("" : "+s"(bid));
        const int lane = tid & 63, wid = __builtin_amdgcn_readfirstlane(tid >> 6);
        const int gw = bid * 8 + wid, NGW = G * 8;
        typedef const unsigned long long __attribute__((address_space(4))) * kptr_t;
        kptr_t kp = (kptr_t)__builtin_amdgcn_kernarg_segment_ptr();
        asm volatile("" : "+s"(kp));
#define ARGF(i) ((const float*)kp[i])
        unsigned char* ws = (unsigned char*)kp[19];
        bf16_t* H = (bf16_t*)(ws + WS_H); bf16_t* Y = (bf16_t*)(ws + WS_Y); bf16_t* POOLED = (bf16_t*)(ws + WS_POOLED); bf16_t* Z = (bf16_t*)(ws + WS_Z);
        float* MOUT = (float*)(ws + WS_MOUT); float* X = (float*)kp[18]; bf16_t* AF = (bf16_t*)(ws + WS_AF);
#define WSB(off) ((bf16_t*)(ws + (off)))
        int type = 0;
        pg8::Gemm g{nullptr, nullptr, MROWS, 0, 0, 0, 0}; pg8::Epi E{nullptr, 0, 0};
        const float *r_m = nullptr, *r_x = nullptr, *r_gp = nullptr, *r_gn = nullptr; float* r_xo = nullptr; bf16_t* r_h = nullptr;
        switch (ph) {
            case 0: type = 0; break;
            case 1: type = 1; g = pg8::Gemm{H, WSB(WS_WIN0), MROWS, DAB, DM, DM, 0}; E = pg8::Epi{Z, DAB, 1}; break;
            case 2: type = 2; break;
            case 3: type = 1; g = pg8::Gemm{POOLED, WSB(WS_POOLW), MROWS, DPOOL, 256, DPOOL, 256}; E = pg8::Epi{Y, DM, 1}; break;
            case 4: type = 1; g = pg8::Gemm{Y, WSB(WS_WOUT0), MROWS, DM, DM, DM, 0}; E = pg8::Epi{MOUT, DM, 0}; break;
            case 5: type = 3; r_m = MOUT; r_x = ARGF(0); r_gp = ARGF(2); r_gn = ARGF(3); r_xo = X; r_h = H; break;
            case 6: type = 1; g = pg8::Gemm{H, WSB(WS_W1_0), MROWS, DFF, DM, DM, 0}; E = pg8::Epi{AF, DFF, 2}; break;
            case 7: type = 1; g = pg8::Gemm{AF, WSB(WS_W2_0), MROWS, DM, DFF, DFF, 0}; E = pg8::Epi{MOUT, DM, 0}; break;
            case 8: type = 3; r_m = MOUT; r_x = X; r_gp = ARGF(4); r_gn = ARGF(1) + DM; r_xo = X; r_h = H; break;
            case 9: type = 1; g = pg8::Gemm{H, WSB(WS_SCIN), MROWS, DSC3, DM, DM, 0}; E = pg8::Epi{Z, DSC3, 1}; break;
            case 10: type = 4; break;
            case 11: type = 1; g = pg8::Gemm{Y, WSB(WS_SCOUT), MROWS, DM, DM, DM, 0}; E = pg8::Epi{MOUT, DM, 0}; break;
            case 12: type = 3; r_m = MOUT; r_x = X; r_gp = ARGF(2) + DM; r_gn = ARGF(3) + DM; r_xo = X; r_h = H; break;
            case 13: type = 1; g = pg8::Gemm{H, WSB(WS_W1_1), MROWS, DFF, DM, DM, 0}; E = pg8::Epi{AF, DFF, 2}; break;
            case 14: type = 1; g = pg8::Gemm{AF, WSB(WS_W2_1), MROWS, DM, DFF, DFF, 0}; E = pg8::Epi{MOUT, DM, 0}; break;
            default: type = 3; r_m = MOUT; r_x = X; r_gp = ARGF(4) + DM; r_gn = nullptr; r_xo = (float*)kp[18]; r_h = nullptr; break;
        }
        if (type == 0) {
            constexpr int I_IN = 32 * 48, I_P = 16, I_OUT = 32 * 32, I_W1 = 32 * 128, I_W2 = 128 * 32, I_SI = 32 * 96, I_SO = 32 * 32;
            constexpr int NITEMS = I_IN + 4 * I_P + I_OUT + 2 * I_W1 + 2 * I_W2 + I_SI + I_SO;
            for (int it = gw; it < NITEMS; it += NGW) {
                int r = it;
                if (r < I_W1) { tr_item(ARGF(16), DM, DFF, WSB(WS_W1_0), r, nullptr, lane); continue; } r -= I_W1;
                if (r < I_W2) { tr_item(ARGF(17), DFF, DM, WSB(WS_W2_0), r, nullptr, lane); continue; } r -= I_W2;
                if (r < I_W1) { tr_item(ARGF(16) + (size_t)DM * DFF, DM, DFF, WSB(WS_W1_1), r, nullptr, lane); continue; } r -= I_W1;
                if (r < I_W2) { tr_item(ARGF(17) + (size_t)DM * DFF, DFF, DM, WSB(WS_W2_1), r, nullptr, lane); continue; } r -= I_W2;
                if (r < I_SI) { tr_item(ARGF(13), DM, DSC3, WSB(WS_SCIN), r, nullptr, lane); continue; } r -= I_SI;
                if (r < I_IN) { tr_item(ARGF(5), DM, DAB, WSB(WS_WIN0), r, nullptr, lane); continue; } r -= I_IN;
                if (r < I_OUT) { tr_item(ARGF(12), DM, DM, WSB(WS_WOUT0), r, nullptr, lane); continue; } r -= I_OUT;
                if (r < I_SO) { tr_item(ARGF(15), DM, DM, WSB(WS_SCOUT), r, nullptr, lane); continue; } r -= I_SO;
                { const int grp = r / I_P, rr = r - grp * I_P; tr_item(ARGF(6) + (size_t)grp * 65536, 256, 256, WSB(WS_POOLW) + (size_t)grp * 65536, rr, ARGF(7) + grp * 256, lane); }
            }
            row_phase(nullptr, ARGF(0), nullptr, ARGF(1), nullptr, H, gw, NGW, lane);
        } else if (type == 1) {
            pg8::StaticOrder S; S.init(g.M, g.N, G, bid);
            pg8::gemm_phase(lds, g, S, E, tid);
        } else if (type == 2) {
            for (int it = bid; it < MROWS / TT; it += G) mix0_item(Z, POOLED, Y, ARGF(8), ARGF(9), ARGF(10), ARGF(11), it, lds, tid, wid, lane);
        } else if (type == 3) {
            row_phase(r_m, r_x, r_gp, r_gn, r_xo, r_h, gw, NGW, lane);
        } else {
            for (int it = bid; it < 256; it += G) sc_chunk(Z, Y, ARGF(14), it * 2 + (tid >> 8), tid & 255);
        }
        if (ph + 1 < a.ph_hi) { if (a.coop) cg::this_grid().sync(); }
    }
}

extern "C" void kernel_launch(void* const* d_in, const int* in_sizes, int n_in, void* d_out, int out_size, void* d_ws, size_t ws_size, hipStream_t stream) {
    static int grid = 0;
    if (grid == 0) {
        if (n_in != 18 || out_size != MROWS * DM || ws_size < WS_END) { fprintf(stderr, "kernel_launch: unexpected shapes (n_in %d out %d ws %zu)\n", n_in, out_size, ws_size); grid = -1; return; }
        int dev = 0, cus = 0, per_cu = 0;
        hipGetDevice(&dev); hipDeviceGetAttribute(&cus, hipDeviceAttributeMultiprocessorCount, dev);
        if (hipFuncSetAttribute((const void*)trunk_fwd, hipFuncAttributeMaxDynamicSharedMemorySize, LDS_BYTES) != hipSuccess) { fprintf(stderr, "kernel_launch: hipFuncSetAttribute failed\n"); grid = -1; return; }
        if (hipOccupancyMaxActiveBlocksPerMultiprocessor(&per_cu, (const void*)trunk_fwd, 512, LDS_BYTES) != hipSuccess || per_cu < 1) { fprintf(stderr, "kernel_launch: occupancy query says %d\n", per_cu); per_cu = 1; }
        (void)hipGetLastError();
        grid = cus * per_cu;
    }
    if (grid < 0) return;
    Args a{};
    for (int i = 0; i < 18; ++i) a.in[i] = (const float*)d_in[i];
    a.out = (float*)d_out; a.ws = (unsigned char*)d_ws;
#if MK_MULTI_LAUNCH
    for (int ph = 0; ph < NPHASES; ++ph) { a.ph_lo = ph; a.ph_hi = ph + 1; a.coop = 0; hipLaunchKernelGGL(trunk_fwd, dim3(grid), dim3(512), LDS_BYTES, stream, a); }
#else
    a.ph_lo = 0; a.ph_hi = NPHASES; a.coop = 1;
    void* args[] = {&a};
    hipError_t e = hipLaunchCooperativeKernel((const void*)trunk_fwd, dim3(grid), dim3(512), args, LDS_BYTES, stream);
    if (e != hipSuccess) fprintf(stderr, "cooperative launch failed: %s (grid %d)\n", hipGetErrorString(e), grid);
#endif
}
```
